# Optimizing an MI355X kernel written in HIP

```python
import math
import jax, jax.numpy as jnp
from jax import lax
import numpy as np


D_MODEL = 1024
BATCH = 8
SEQ = 2048
DEPTH = 2

D_MIX = D_MODEL
D_CONV = D_MIX // 4
D_LRU = D_MIX // 4
D_ATTN = D_MIX // 2
CONV_KERNEL = 31
LRU_HEADS = 4
LRU_HEAD_DIM = D_LRU // LRU_HEADS
LRU_CONV = 4
LRU_C = 8.0
HEAD_DIM = 64
N_Q_HEADS = D_ATTN // HEAD_DIM
N_KV_HEADS = 2
GQA_REP = N_Q_HEADS // N_KV_HEADS
KV_DIM = N_KV_HEADS * HEAD_DIM
WINDOW = 128
BLOCK = 128
REL_BUCKETS = 32
REL_MAX_DIST = 128
D_FF = 2816
ALPHA = (2.0 * DEPTH) ** 0.25
BETA = (8.0 * DEPTH) ** -0.25
LN_EPS = 1e-5
D_IN = 2 * D_CONV + 2 * D_LRU + D_ATTN + 2 * KV_DIM

kernel_name = 'hymba_conv_rglru_swa_macaron_deepnorm'


def _layernorm(x, g, b):
    xf = x.astype(jnp.float32)
    mu = jnp.mean(xf, axis=-1, keepdims=True)
    var = jnp.mean(jnp.square(xf - mu), axis=-1, keepdims=True)
    return ((xf - mu) * lax.rsqrt(var + LN_EPS)).astype(x.dtype) * g + b


def _swiglu(x, wg, wu, wd):
    return (jax.nn.silu(x @ wg) * (x @ wu)) @ wd


def _causal_dw_conv(x, w):
    k = w.shape[0]
    return lax.conv_general_dilated(
        x, w[:, None, :].astype(x.dtype), window_strides=(1,), padding=[(k - 1, 0)],
        dimension_numbers=('NWC', 'WIO', 'NWC'), feature_group_count=x.shape[-1])


def _conv_module(u, dw_w, dw_b, g, b):
    a, gate = jnp.split(u, 2, axis=-1)
    y = a * jax.nn.sigmoid(gate)
    y = _causal_dw_conv(y, dw_w) + dw_b
    y = _layernorm(y, g, b)
    return jax.nn.silu(y)


def _lin_combine(left, right):
    a1, b1 = left
    a2, b2 = right
    return a1 * a2, a2 * b1 + b2


def _recurrent(u, conv_w, conv_b, wa, ba, wx, bx, lam):
    B, S, _ = u.shape
    xb, gb = jnp.split(u, 2, axis=-1)
    xb = _causal_dw_conv(xb, conv_w) + conv_b
    xh = xb.reshape(B, S, LRU_HEADS, LRU_HEAD_DIM)
    r = jax.nn.sigmoid(jnp.einsum('bshi,hij->bshj', xh, wa).reshape(B, S, D_LRU) + ba)
    i = jax.nn.sigmoid(jnp.einsum('bshi,hij->bshj', xh, wx).reshape(B, S, D_LRU) + bx)
    log_a = LRU_C * r.astype(jnp.float32) * jax.nn.log_sigmoid(lam.astype(jnp.float32))
    a = jnp.exp(log_a)
    mult = jnp.sqrt(-jnp.expm1(2.0 * log_a))
    bterm = mult * (i * xb).astype(jnp.float32)
    _, h = lax.associative_scan(_lin_combine, (a, bterm), axis=1)
    return h.astype(u.dtype) * jax.nn.gelu(gb)


def _rel_bucket(dist):
    max_exact = REL_BUCKETS // 2
    is_small = dist < max_exact
    large = max_exact + (jnp.log(jnp.maximum(dist, 1).astype(jnp.float32) / max_exact)
                         / math.log(REL_MAX_DIST / max_exact)
                         * (REL_BUCKETS - max_exact)).astype(jnp.int32)
    large = jnp.minimum(large, REL_BUCKETS - 1)
    return jnp.where(is_small, dist, large)


def _band_bias_and_mask(rel_bias, seq):
    nb = seq // BLOCK
    qi = jnp.arange(BLOCK)[:, None]
    kj = jnp.arange(2 * BLOCK)[None, :]
    dist = qi - kj + BLOCK
    bucket = _rel_bucket(jnp.maximum(dist, 0))
    bias = rel_bias[bucket].astype(jnp.float32)
    bias = jnp.transpose(bias, (2, 0, 1)).reshape(N_KV_HEADS, GQA_REP, BLOCK, 2 * BLOCK)
    blk = jnp.arange(nb)[:, None, None]
    valid = (dist >= 0) & (dist < WINDOW) & (blk * BLOCK + kj - BLOCK >= 0)
    return bias, valid


def _band(t, nb):
    B = t.shape[0]
    tp = jnp.pad(t, ((0, 0), (BLOCK, 0), (0, 0), (0, 0)))
    tp = tp.reshape(B, nb + 1, BLOCK, t.shape[2], t.shape[3])
    return jnp.concatenate([tp[:, :-1], tp[:, 1:]], axis=2)


def _swa(q, k, v, band_bias, valid, sinks):
    B, S, _ = q.shape
    nb = S // BLOCK
    qb = q.reshape(B, nb, BLOCK, N_KV_HEADS, GQA_REP, HEAD_DIM)
    kb = _band(k.reshape(B, S, N_KV_HEADS, HEAD_DIM), nb)
    vb = _band(v.reshape(B, S, N_KV_HEADS, HEAD_DIM), nb)
    s = jnp.einsum('bnqgrd,bnkgd->bngrqk', qb, kb).astype(jnp.float32) * (HEAD_DIM ** -0.5)
    s = s + band_bias[None, None]
    s = jnp.where(valid[None, :, None, None], s, -1e30)
    sink = jnp.broadcast_to(sinks.astype(jnp.float32).reshape(1, 1, N_KV_HEADS, GQA_REP, 1, 1),
                            s.shape[:-1] + (1,))
    p = jax.nn.softmax(jnp.concatenate([s, sink], axis=-1), axis=-1)[..., :-1]
    o = jnp.einsum('bngrqk,bnkgd->bnqgrd', p.astype(vb.dtype), vb)
    return o.reshape(B, S, D_ATTN)


def _mixer(x, w_in, conv_dw_w, conv_dw_b, conv_ln_g, conv_ln_b, lru_conv_w, lru_conv_b,
           lru_wa, lru_ba, lru_wx, lru_bx, lru_lambda, sinks, w_out, band_bias, valid):
    u = x @ w_in
    o1 = 2 * D_CONV
    o2 = o1 + 2 * D_LRU
    o3 = o2 + D_ATTN
    o4 = o3 + KV_DIM
    u_conv, u_lru, q, k, v = jnp.split(u, [o1, o2, o3, o4], axis=-1)
    y_conv = _conv_module(u_conv, conv_dw_w, conv_dw_b, conv_ln_g, conv_ln_b)
    y_lru = _recurrent(u_lru, lru_conv_w, lru_conv_b, lru_wa, lru_ba, lru_wx, lru_bx, lru_lambda)
    y_attn = _swa(q, k, v, band_bias, valid, sinks)
    return jnp.concatenate([y_conv, y_lru, y_attn], axis=-1) @ w_out


def setup_inputs(seed: int = 0) -> dict:
    key = jax.random.key(seed)
    ks = jax.random.split(key, 24)
    f32 = jnp.float32
    nrm = lambda k, shape, scale: jax.random.normal(k, shape, f32) * scale
    x = nrm(ks[0], (BATCH, SEQ, D_MODEL), 1.0)
    rel_bias = nrm(ks[1], (REL_BUCKETS, N_Q_HEADS), 0.5)
    ln_g = 1.0 + nrm(ks[2], (DEPTH, 3, D_MODEL), 0.1)
    ln_b = nrm(ks[3], (DEPTH, 3, D_MODEL), 0.02)
    ffn_w_gate = nrm(ks[4], (DEPTH, 2, D_MODEL, D_FF), D_MODEL ** -0.5)
    ffn_w_up = nrm(ks[5], (DEPTH, 2, D_MODEL, D_FF), D_MODEL ** -0.5)
    ffn_w_down = nrm(ks[6], (DEPTH, 2, D_FF, D_MODEL), BETA * D_FF ** -0.5)
    w_in = nrm(ks[7], (DEPTH, D_MODEL, D_IN), D_MODEL ** -0.5)
    conv_dw_w = nrm(ks[8], (DEPTH, CONV_KERNEL, D_CONV), CONV_KERNEL ** -0.5)
    conv_dw_b = nrm(ks[9], (DEPTH, D_CONV), 0.02)
    conv_ln_g = 1.0 + nrm(ks[10], (DEPTH, D_CONV), 0.1)
    conv_ln_b = nrm(ks[11], (DEPTH, D_CONV), 0.02)
    lru_conv_w = nrm(ks[12], (DEPTH, LRU_CONV, D_LRU), LRU_CONV ** -0.5)
    lru_conv_b = nrm(ks[13], (DEPTH, D_LRU), 0.02)
    lru_wa = nrm(ks[14], (DEPTH, LRU_HEADS, LRU_HEAD_DIM, LRU_HEAD_DIM), LRU_HEAD_DIM ** -0.5)
    lru_ba = nrm(ks[15], (DEPTH, D_LRU), 0.02)
    lru_wx = nrm(ks[16], (DEPTH, LRU_HEADS, LRU_HEAD_DIM, LRU_HEAD_DIM), LRU_HEAD_DIM ** -0.5)
    lru_bx = nrm(ks[17], (DEPTH, D_LRU), 0.02)
    a_init = jax.random.uniform(ks[18], (DEPTH, D_LRU), f32, 0.9, 0.999)
    sig = a_init ** (1.0 / LRU_C)
    lru_lambda = jnp.log(sig) - jnp.log1p(-sig)
    attn_sinks = nrm(ks[19], (DEPTH, N_Q_HEADS), 0.5)
    w_out = nrm(ks[20], (DEPTH, D_MIX, D_MODEL), BETA * D_MIX ** -0.5)
    return {'x': x, 'rel_bias': rel_bias, 'ln_g': ln_g, 'ln_b': ln_b,
            'ffn_w_gate': ffn_w_gate, 'ffn_w_up': ffn_w_up, 'ffn_w_down': ffn_w_down,
            'w_in': w_in, 'conv_dw_w': conv_dw_w, 'conv_dw_b': conv_dw_b,
            'conv_ln_g': conv_ln_g, 'conv_ln_b': conv_ln_b,
            'lru_conv_w': lru_conv_w, 'lru_conv_b': lru_conv_b,
            'lru_wa': lru_wa, 'lru_ba': lru_ba, 'lru_wx': lru_wx, 'lru_bx': lru_bx,
            'lru_lambda': lru_lambda, 'attn_sinks': attn_sinks, 'w_out': w_out}


def reference(x, rel_bias, ln_g, ln_b, ffn_w_gate, ffn_w_up, ffn_w_down, w_in,
              conv_dw_w, conv_dw_b, conv_ln_g, conv_ln_b, lru_conv_w, lru_conv_b,
              lru_wa, lru_ba, lru_wx, lru_bx, lru_lambda, attn_sinks, w_out):
    band_bias, valid = _band_bias_and_mask(rel_bias, x.shape[1])
    for l in range(DEPTH):
        h = 0.5 * _swiglu(x, ffn_w_gate[l, 0], ffn_w_up[l, 0], ffn_w_down[l, 0])
        x = _layernorm(ALPHA * x + h, ln_g[l, 0], ln_b[l, 0])
        h = _mixer(x, w_in[l], conv_dw_w[l], conv_dw_b[l], conv_ln_g[l], conv_ln_b[l],
                   lru_conv_w[l], lru_conv_b[l], lru_wa[l], lru_ba[l], lru_wx[l], lru_bx[l],
                   lru_lambda[l], attn_sinks[l], w_out[l], band_bias, valid)
        x = _layernorm(ALPHA * x + h, ln_g[l, 1], ln_b[l, 1])
        h = 0.5 * _swiglu(x, ffn_w_gate[l, 1], ffn_w_up[l, 1], ffn_w_down[l, 1])
        x = _layernorm(ALPHA * x + h, ln_g[l, 2], ln_b[l, 2])
    return x
```

```cpp
#include <hip/hip_runtime.h>
#include <cstdio>
#include <cstdint>
#include <cmath>

namespace nv {
constexpr int D = 1024, BATCH = 8, SEQ = 2048, M = BATCH * SEQ, DEPTH = 2;
constexpr int DFF = 2816, DIN = 1792, DCONV = 256, DLRU = 256, DATT = 512;
constexpr int CK = 31, LCK = 4;
constexpr float ALPHA = 1.41421356237309515f;
constexpr float LN_EPS = 1e-5f;

__device__ __forceinline__ float sigmoidf_(float x) { return 1.f / (1.f + expf(-x)); }
__device__ __forceinline__ float siluf_(float x) { return x / (1.f + expf(-x)); }
__device__ __forceinline__ float gelu_tanh(float x) { const float c = 0.7978845608028654f; return 0.5f * x * (1.f + tanhf(c * (x + 0.044715f * x * x * x))); }

template <int MODE>
__global__ void __launch_bounds__(256) gemm_f32(const float* __restrict__ A, int lda, const float* __restrict__ W, const float* __restrict__ W2, int ldw,
                                                float* __restrict__ C, int ldc, int K) {
    __shared__ float As[16][68];
    __shared__ float Ws[16][68];
    __shared__ float Ws2[16][68];
    const int tid = threadIdx.x, tx = tid & 15, ty = tid >> 4;
    const int m0 = blockIdx.y * 64, n0 = blockIdx.x * 64;
    float acc[4][4], acc2[4][4];
#pragma unroll
    for (int i = 0; i < 4; ++i)
#pragma unroll
        for (int j = 0; j < 4; ++j) { acc[i][j] = 0.f; acc2[i][j] = 0.f; }
    const int ar = tid >> 2, ak = (tid & 3) * 4;
    const int wk = tid >> 4, wn = (tid & 15) * 4;
    for (int k0 = 0; k0 < K; k0 += 16) {
        const float4 av = *(const float4*)(A + (size_t)(m0 + ar) * lda + k0 + ak);
        As[ak + 0][ar] = av.x; As[ak + 1][ar] = av.y; As[ak + 2][ar] = av.z; As[ak + 3][ar] = av.w;
        const float4 wv = *(const float4*)(W + (size_t)(k0 + wk) * ldw + n0 + wn);
        Ws[wk][wn + 0] = wv.x; Ws[wk][wn + 1] = wv.y; Ws[wk][wn + 2] = wv.z; Ws[wk][wn + 3] = wv.w;
        if (MODE == 1) {
            const float4 w2 = *(const float4*)(W2 + (size_t)(k0 + wk) * ldw + n0 + wn);
            Ws2[wk][wn + 0] = w2.x; Ws2[wk][wn + 1] = w2.y; Ws2[wk][wn + 2] = w2.z; Ws2[wk][wn + 3] = w2.w;
        }
        __syncthreads();
#pragma unroll
        for (int k = 0; k < 16; ++k) {
            float a[4], b[4], b2[4];
#pragma unroll
            for (int i = 0; i < 4; ++i) a[i] = As[k][ty * 4 + i];
#pragma unroll
            for (int j = 0; j < 4; ++j) { b[j] = Ws[k][tx * 4 + j]; if (MODE == 1) b2[j] = Ws2[k][tx * 4 + j]; }
#pragma unroll
            for (int i = 0; i < 4; ++i)
#pragma unroll
                for (int j = 0; j < 4; ++j) { acc[i][j] = fmaf(a[i], b[j], acc[i][j]); if (MODE == 1) acc2[i][j] = fmaf(a[i], b2[j], acc2[i][j]); }
        }
        __syncthreads();
    }
#pragma unroll
    for (int i = 0; i < 4; ++i) {
        float4 o;
        if (MODE == 1) { o.x = siluf_(acc[i][0]) * acc2[i][0]; o.y = siluf_(acc[i][1]) * acc2[i][1]; o.z = siluf_(acc[i][2]) * acc2[i][2]; o.w = siluf_(acc[i][3]) * acc2[i][3]; }
        else { o.x = acc[i][0]; o.y = acc[i][1]; o.z = acc[i][2]; o.w = acc[i][3]; }
        *(float4*)(C + (size_t)(m0 + ty * 4 + i) * ldc + n0 + tx * 4) = o;
    }
}

__device__ __forceinline__ float wave_sum(float v) {
#pragma unroll
    for (int o = 1; o < 64; o <<= 1) v += __shfl_xor(v, o);
    return v;
}

__global__ void __launch_bounds__(256) ln_residual(const float* __restrict__ xin, const float* __restrict__ h, float s, const float* __restrict__ g, const float* __restrict__ b, float* __restrict__ xout) {
    const int lane = threadIdx.x & 63, row = blockIdx.x * 4 + (threadIdx.x >> 6);
    float v[16]; float sum = 0.f;
#pragma unroll
    for (int j = 0; j < 4; ++j) {
        const float4 xv = *(const float4*)(xin + (size_t)row * D + j * 256 + lane * 4);
        const float4 hv = *(const float4*)(h + (size_t)row * D + j * 256 + lane * 4);
        v[j * 4 + 0] = ALPHA * xv.x + s * hv.x; v[j * 4 + 1] = ALPHA * xv.y + s * hv.y; v[j * 4 + 2] = ALPHA * xv.z + s * hv.z; v[j * 4 + 3] = ALPHA * xv.w + s * hv.w;
        sum += (v[j * 4 + 0] + v[j * 4 + 1]) + (v[j * 4 + 2] + v[j * 4 + 3]);
    }
    const float mean = wave_sum(sum) * (1.f / D); float sq = 0.f;
#pragma unroll
    for (int i = 0; i < 16; ++i) { v[i] -= mean; sq += v[i] * v[i]; }
    const float rstd = rsqrtf(wave_sum(sq) * (1.f / D) + LN_EPS);
#pragma unroll
    for (int j = 0; j < 4; ++j) {
        const float4 gv = *(const float4*)(g + j * 256 + lane * 4); const float4 bv = *(const float4*)(b + j * 256 + lane * 4);
        float4 o; o.x = v[j * 4 + 0] * rstd * gv.x + bv.x; o.y = v[j * 4 + 1] * rstd * gv.y + bv.y; o.z = v[j * 4 + 2] * rstd * gv.z + bv.z; o.w = v[j * 4 + 3] * rstd * gv.w + bv.w;
        *(float4*)(xout + (size_t)row * D + j * 256 + lane * 4) = o;
    }
}

__global__ void __launch_bounds__(256) conv_module(const float* __restrict__ u, const float* __restrict__ dw_w, const float* __restrict__ dw_b, const float* __restrict__ lg, const float* __restrict__ lb, float* __restrict__ Y) {
    __shared__ float red[8];
    const int c = threadIdx.x, m = blockIdx.x, t = m % SEQ;
    float acc = dw_b[c];
    for (int j = 0; j < CK; ++j) {
        const int tt = t - (CK - 1) + j;
        if (tt >= 0) {
            const float* ur = u + (size_t)(m - (CK - 1) + j) * DIN;
            const float a = ur[c], gt = ur[DCONV + c];
            acc = fmaf(dw_w[j * DCONV + c], a * sigmoidf_(gt), acc);
        }
    }
    float s = wave_sum(acc);
    if ((c & 63) == 0) red[c >> 6] = s;
    __syncthreads();
    const float mean = (red[0] + red[1] + red[2] + red[3]) * (1.f / DCONV);
    const float d = acc - mean;
    float q = wave_sum(d * d);
    if ((c & 63) == 0) red[4 + (c >> 6)] = q;
    __syncthreads();
    const float var = (red[4] + red[5] + red[6] + red[7]) * (1.f / DCONV);
    const float y = d * rsqrtf(var + LN_EPS) * lg[c] + lb[c];
    Y[(size_t)m * D + c] = siluf_(y);
}

__global__ void __launch_bounds__(256) lru_pre(const float* __restrict__ u, const float* __restrict__ cw, const float* __restrict__ cb, const float* __restrict__ wa, const float* __restrict__ ba,
                                               const float* __restrict__ wx, const float* __restrict__ bx, const float* __restrict__ lam, float* __restrict__ Aout, float* __restrict__ Bout) {
    __shared__ float xs[DLRU];
    const int c = threadIdx.x, m = blockIdx.x, t = m % SEQ;
    float xb = cb[c];
    for (int j = 0; j < LCK; ++j) {
        const int tt = t - (LCK - 1) + j;
        if (tt >= 0) xb = fmaf(cw[j * DLRU + c], u[(size_t)(m - (LCK - 1) + j) * DIN + 512 + c], xb);
    }
    xs[c] = xb;
    __syncthreads();
    const int hd = c >> 6, jj = c & 63;
    float ra = ba[c], ri = bx[c];
    for (int i = 0; i < 64; ++i) {
        const float xv = xs[hd * 64 + i];
        ra = fmaf(xv, wa[(hd * 64 + i) * 64 + jj], ra);
        ri = fmaf(xv, wx[(hd * 64 + i) * 64 + jj], ri);
    }
    const float r = sigmoidf_(ra), ig = sigmoidf_(ri);
    const float L = lam[c];
    const float ls = fminf(L, 0.f) - log1pf(expf(-fabsf(L)));
    const float log_a = 8.0f * r * ls;
    const float a = expf(log_a);
    const float mult = sqrtf(-expm1f(2.0f * log_a));
    Aout[(size_t)m * DLRU + c] = a;
    Bout[(size_t)m * DLRU + c] = mult * (ig * xb);
}
__global__ void __launch_bounds__(256) lru_scan(const float* __restrict__ Ain, const float* __restrict__ Bin, const float* __restrict__ u, float* __restrict__ Y) {
    const int c = threadIdx.x, b = blockIdx.x;
    float h = 0.f;
    for (int t = 0; t < SEQ; ++t) {
        const size_t m = (size_t)b * SEQ + t;
        h = fmaf(Ain[m * DLRU + c], h, Bin[m * DLRU + c]);
        Y[m * D + 256 + c] = h * gelu_tanh(u[m * DIN + 768 + c]);
    }
}

__global__ void __launch_bounds__(512) attn_naive(const float* __restrict__ u, const float* __restrict__ rel_bias, const float* __restrict__ sinks, float* __restrict__ Y) {
    __shared__ float qs[512];
    __shared__ float ps[8][128];
    const int tid = threadIdx.x, hq = tid >> 6, j = tid & 63, m = blockIdx.x, t = m % SEQ, g = hq >> 2;
    qs[tid] = u[(size_t)m * DIN + 1024 + tid];
    __syncthreads();
    float sc[2];
#pragma unroll
    for (int e = 0; e < 2; ++e) {
        const int dist = j + 64 * e;
        if (dist <= t) {
            const float* kr = u + (size_t)(m - dist) * DIN + 1536 + g * 64;
            float dot = 0.f;
            for (int d = 0; d < 64; ++d) dot = fmaf(qs[hq * 64 + d], kr[d], dot);
            int bucket;
            if (dist < 16) bucket = dist;
            else { bucket = 16 + (int)(logf((float)dist / 16.0f) / logf(8.0f) * 16.0f); if (bucket > 31) bucket = 31; }
            sc[e] = dot * 0.125f + rel_bias[bucket * 8 + hq];
        } else sc[e] = -1e30f;
    }
    const float sink = sinks[hq];
    float mx = fmaxf(fmaxf(sc[0], sc[1]), sink);
#pragma unroll
    for (int o = 1; o < 64; o <<= 1) mx = fmaxf(mx, __shfl_xor(mx, o));
    const float p0 = expf(sc[0] - mx), p1 = expf(sc[1] - mx);
    const float den = wave_sum(p0 + p1) + expf(sink - mx);
    ps[hq][j] = p0 / den; ps[hq][j + 64] = p1 / den;
    __syncthreads();
    float o = 0.f;
    const int nk = (t < 127 ? t : 127) + 1;
    for (int dist = 0; dist < nk; ++dist) o = fmaf(ps[hq][dist], u[(size_t)(m - dist) * DIN + 1664 + g * 64 + j], o);
    Y[(size_t)m * D + 512 + hq * 64 + j] = o;
}
}

extern "C" void kernel_launch(void* const* d_in, const int* in_sizes, int n_in, void* d_out, int out_size, void* d_ws, size_t ws_size, hipStream_t stream) {
    using namespace nv;
    const float* x_in = (const float*)d_in[0];
    const float* rel_bias = (const float*)d_in[1];
    const float* ln_g = (const float*)d_in[2];
    const float* ln_b = (const float*)d_in[3];
    const float* wg = (const float*)d_in[4];
    const float* wu = (const float*)d_in[5];
    const float* wd = (const float*)d_in[6];
    const float* w_in = (const float*)d_in[7];
    const float* conv_dw_w = (const float*)d_in[8];
    const float* conv_dw_b = (const float*)d_in[9];
    const float* conv_ln_g = (const float*)d_in[10];
    const float* conv_ln_b = (const float*)d_in[11];
    const float* lru_conv_w = (const float*)d_in[12];
    const float* lru_conv_b = (const float*)d_in[13];
    const float* lru_wa = (const float*)d_in[14];
    const float* lru_ba = (const float*)d_in[15];
    const float* lru_wx = (const float*)d_in[16];
    const float* lru_bx = (const float*)d_in[17];
    const float* lru_lambda = (const float*)d_in[18];
    const float* attn_sinks = (const float*)d_in[19];
    const float* w_out = (const float*)d_in[20];
    float* X = (float*)d_out;
    float* ws = (float*)d_ws;
    float* ACT = ws;
    float* U = ws;
    float* Yb = ws + (size_t)M * DIN;
    float* H = ws + (size_t)M * DFF;
    float* LA = H; float* LB = H + (size_t)M * DLRU;
    if ((size_t)M * (DFF + D) * 4 > ws_size) { fprintf(stderr, "workspace too small\n"); return; }

    for (int l = 0; l < DEPTH; ++l) {
        for (int f = 0; f < 2; ++f) {
            if (f == 1) {
                const float* xin = X;
                gemm_f32<0><<<dim3(DIN / 64, M / 64), 256, 0, stream>>>(xin, D, w_in + (size_t)l * D * DIN, nullptr, DIN, U, DIN, D);
                conv_module<<<M, 256, 0, stream>>>(U, conv_dw_w + (size_t)l * CK * DCONV, conv_dw_b + l * DCONV, conv_ln_g + l * DCONV, conv_ln_b + l * DCONV, Yb);
                lru_pre<<<M, 256, 0, stream>>>(U, lru_conv_w + (size_t)l * LCK * DLRU, lru_conv_b + l * DLRU, lru_wa + (size_t)l * 4 * 64 * 64, lru_ba + l * DLRU,
                                               lru_wx + (size_t)l * 4 * 64 * 64, lru_bx + l * DLRU, lru_lambda + l * DLRU, LA, LB);
                lru_scan<<<BATCH, 256, 0, stream>>>(LA, LB, U, Yb);
                attn_naive<<<M, 512, 0, stream>>>(U, rel_bias, attn_sinks + l * 8, Yb);
                gemm_f32<0><<<dim3(D / 64, M / 64), 256, 0, stream>>>(Yb, D, w_out + (size_t)l * D * D, nullptr, D, H, D, D);
                ln_residual<<<M / 4, 256, 0, stream>>>(X, H, 1.0f, ln_g + (size_t)(l * 3 + 1) * D, ln_b + (size_t)(l * 3 + 1) * D, X);
            }
            const float* xin = (l == 0 && f == 0) ? x_in : X;
            const size_t wo = (size_t)(l * 2 + f) * D * DFF;
            gemm_f32<1><<<dim3(DFF / 64, M / 64), 256, 0, stream>>>(xin, D, wg + wo, wu + wo, DFF, ACT, DFF, D);
            gemm_f32<0><<<dim3(D / 64, M / 64), 256, 0, stream>>>(ACT, DFF, wd + wo, nullptr, D, H, D, DFF);
            const int li = l * 3 + (f == 0 ? 0 : 2);
            ln_residual<<<M / 4, 256, 0, stream>>>(xin, H, 0.5f, ln_g + (size_t)li * D, ln_b + (size_t)li * D, X);
        }
    }
}
```
